# Optimizing an MI355X kernel written in HIP

```python
import jax, jax.numpy as jnp
from jax import lax
import numpy as np

D_MODEL = 1024
BATCH = 2
SEQ = 8192
DEPTH = 1
DEC_BATCH = 16
DEC_SEQ = 16
PAST_LEN = 1024

CHUNK = 64
MIX = D_MODEL
D_A = MIX // 2
D_B = MIX - D_A
H_A = 4
DK = D_A // H_A
DV = D_A // H_A
H_B = 4
C_B = D_B // H_B
MLP_CHUNK = 128
IN_WIDTH = 4 * D_A + 3 * D_B
EPS = 1e-6

kernel_name = "hgrn2_chunkmlp_hybrid_stream_step"


def rmsnorm(x, w):
    xf = x.astype(jnp.float32)
    y = xf * lax.rsqrt(jnp.mean(xf * xf, axis=-1, keepdims=True) + EPS)
    return (y * w.astype(jnp.float32)).astype(x.dtype)


def hgrn2_chunkwise(q, k, v, logf, s0, chunk):
    bsz, t, _ = q.shape
    n = t // chunk

    def heads(a, d):
        return a.reshape(bsz, n, chunk, H_A, d).transpose(1, 0, 3, 2, 4)

    qc, kc, gc, vc = heads(q, DK), heads(k, DK), heads(logf, DK), heads(v, DV)
    causal = jnp.tril(jnp.ones((chunk, chunk), dtype=bool))[:, :, None]

    def step(s, xs):
        qb, kb, vb, gb = xs
        b = jnp.cumsum(gb, axis=2)
        inter = jnp.einsum("bhtk,bhkv->bhtv", qb * jnp.exp(b), s)
        diff = b[:, :, :, None, :] - b[:, :, None, :, :]
        decay = jnp.exp(jnp.where(causal, diff, -jnp.inf))
        scores = jnp.einsum("bhtk,bhsk,bhtsk->bhts", qb, kb, decay)
        intra = jnp.einsum("bhts,bhsv->bhtv", scores, vb)
        b_last = b[:, :, -1, :]
        s_new = s * jnp.exp(b_last)[..., None] + jnp.einsum(
            "bhsk,bhsv->bhkv", kb * jnp.exp(b_last[:, :, None, :] - b), vb)
        return s_new, inter + intra

    s_fin, o = lax.scan(step, s0, (qc, kc, vc, gc))
    o = o.transpose(1, 0, 3, 2, 4).reshape(bsz, t, H_A * DV)
    return o, s_fin


def spatial_mix(v, w_s, b_s):
    bsz, t, _ = v.shape
    L = min(MLP_CHUNK, t)
    n = t // L
    w = jnp.tril(w_s[:, :L, :L].astype(jnp.float32))
    bias = b_s[:, :L].astype(jnp.float32).T
    vc = v.reshape(bsz, n, L, H_B, C_B)
    out = jnp.einsum("hts,bnshc->bnthc", w, vc) + bias[None, None, :, :, None]
    return out.reshape(bsz, t, D_B)


def mixer_layer(x, s0, norm_w, w_in, lb, g_norm_w, ln_v_w, ln_v_b, w_s, b_s, w_out):
    bsz, t, _ = x.shape
    h = rmsnorm(x, norm_w)
    z = jnp.einsum("btd,de->bte", h, w_in).astype(jnp.float32)
    q = z[..., 0:D_A]
    f_raw = z[..., D_A:2 * D_A]
    i = z[..., 2 * D_A:3 * D_A]
    g_a = z[..., 3 * D_A:4 * D_A]
    u = z[..., 4 * D_A:4 * D_A + D_B]
    v = z[..., 4 * D_A + D_B:4 * D_A + 2 * D_B]
    g_b = z[..., 4 * D_A + 2 * D_B:]

    f = lb + (1.0 - lb) * jax.nn.sigmoid(f_raw)
    o_a, s_fin = hgrn2_chunkwise(jax.nn.silu(q) * (DK ** -0.5), 1.0 - f, i, jnp.log(f),
                                 s0.astype(jnp.float32), min(CHUNK, t))
    o_a = o_a.reshape(bsz, t, H_A, DV)
    o_a = o_a * lax.rsqrt(jnp.mean(o_a * o_a, axis=-1, keepdims=True) + EPS)
    y_a = o_a.reshape(bsz, t, D_A) * g_norm_w.astype(jnp.float32) * jax.nn.silu(g_a)

    u = jax.nn.gelu(u, approximate=False)
    v = jax.nn.gelu(v, approximate=False)
    mu = jnp.mean(v, axis=-1, keepdims=True)
    var = jnp.mean(jnp.square(v - mu), axis=-1, keepdims=True)
    v = (v - mu) * lax.rsqrt(var + EPS) * ln_v_w.astype(jnp.float32) + ln_v_b.astype(jnp.float32)
    y_b = u * spatial_mix(v, w_s, b_s) * jax.nn.silu(g_b)

    y = jnp.concatenate([y_a, y_b], axis=-1).astype(x.dtype)
    out = x + jnp.einsum("bte,ed->btd", y, w_out).astype(x.dtype)
    return out, s_fin, v.astype(x.dtype)


def setup_inputs(seed: int = 0) -> dict:
    key = jax.random.key(seed)
    ks = jax.random.split(key, 14)
    f32 = jnp.float32
    return {
        "x_prompt": jax.random.normal(ks[0], (BATCH, SEQ, D_MODEL), f32),
        "x_sample": jax.random.normal(ks[1], (DEC_BATCH, DEC_SEQ, D_MODEL), f32),
        "state_hgrn": 0.5 * jax.random.normal(ks[2], (DEPTH, DEC_BATCH, H_A, DK, DV), f32),
        "norm_w": 1.0 + 0.02 * jax.random.normal(ks[3], (DEPTH, D_MODEL), f32),
        "w_in": jax.random.normal(ks[4], (DEPTH, D_MODEL, IN_WIDTH), f32) * D_MODEL ** -0.5,
        "lb_logits": 0.1 * jax.random.normal(ks[5], (DEPTH + 1, D_A), f32),
        "g_norm_w": 1.0 + 0.02 * jax.random.normal(ks[6], (DEPTH, D_A), f32),
        "ln_v_w": 1.0 + 0.02 * jax.random.normal(ks[7], (DEPTH, D_B), f32),
        "ln_v_b": 0.02 * jax.random.normal(ks[8], (DEPTH, D_B), f32),
        "w_s": jax.random.normal(ks[9], (DEPTH, H_B, MLP_CHUNK, MLP_CHUNK), f32) * MLP_CHUNK ** -0.5,
        "b_s": 1.0 + 0.1 * jax.random.normal(ks[10], (DEPTH, H_B, MLP_CHUNK), f32),
        "w_out": jax.random.normal(ks[11], (DEPTH, MIX, D_MODEL), f32) * MIX ** -0.5,
        "final_norm_w": 1.0 + 0.02 * jax.random.normal(ks[12], (D_MODEL,), f32),
    }


def reference(x_prompt, x_sample, state_hgrn, norm_w, w_in, lb_logits, g_norm_w, ln_v_w, ln_v_b,
              w_s, b_s, w_out, final_norm_w):
    lb_all = jnp.cumsum(jax.nn.softmax(lb_logits.astype(jnp.float32), axis=0), axis=0)
    hp, hs = x_prompt, x_sample
    sp_list, ss_list, v_list = [], [], []
    for l in range(DEPTH):
        params = (norm_w[l], w_in[l], lb_all[l], g_norm_w[l], ln_v_w[l], ln_v_b[l], w_s[l], b_s[l], w_out[l])
        s0_prompt = jnp.zeros((x_prompt.shape[0], H_A, DK, DV), jnp.float32)
        hp, s_p, _ = mixer_layer(hp, s0_prompt, *params)
        hs, s_s, v_s = mixer_layer(hs, state_hgrn[l], *params)
        sp_list.append(s_p)
        ss_list.append(s_s)
        v_list.append(v_s)
    y_prompt = rmsnorm(hp, final_norm_w)
    y_sample = rmsnorm(hs, final_norm_w)
    state_hgrn_prompt = jnp.stack(sp_list, axis=0)
    state_hgrn_sample = jnp.stack(ss_list, axis=0)
    mlp_v_sample = jnp.stack(v_list, axis=0)
    return (y_prompt, y_sample, state_hgrn_prompt, state_hgrn_sample, mlp_v_sample)
```

```cpp
#include <hip/hip_runtime.h>
#include <cstdio>
#include <cstdint>
namespace pg8 {
#define PG8_LAS __attribute__((address_space(3)))
typedef unsigned short bf16_t;
typedef short bf16x8 __attribute__((ext_vector_type(8)));
typedef float f32x4 __attribute__((ext_vector_type(4)));
typedef unsigned u32x4 __attribute__((ext_vector_type(4)));
constexpr int BM = 256, BK = 64, HALF = 128, HTB = HALF * BK * 2  , STAGE_BYTES = 8 * HTB, NXCD = 8, WGM = 8;

__host__ __device__ __forceinline__ int lds_byte(int r, int c) { const int st = (r >> 4) * 2 + (c >> 5), rr = r & 15, cc = c & 31, ob = rr * 64 + cc * 2; return st * 1024 + (ob ^ (((ob >> 9) & 1) << 5)); }
__host__ __device__ __forceinline__ void stage_rc(int b, int& R, int& C) { const int st = b / 1024, sb = b % 1024, swz = sb ^ (((sb >> 9) & 1) << 5); R = (st >> 1) * 16 + swz / 64; C = (st & 1) * 32 + (swz % 64) / 2; }
__host__ __device__ __forceinline__ int perm32(int rho) { const int n = rho >> 4, i = rho & 15; return 8 * (i >> 2) + 4 * n + (i & 3); }

struct Unit { int pm, pn; };
struct Gemm { const bf16_t* A; const bf16_t* Bt; int M, N, K; };

struct StaticOrder {
    int nM, nN, nwg, G, c;
    __host__ __device__ void init(int M, int N, int G_, int c_) { nM = M / BM; nN = N / BM; nwg = nM * nN; G = G_; c = c_; }
    __host__ __device__ bool next(int i, Unit& u) const {
        const long L = (long)i * G + c; if (L >= nwg) return false;
        int wgid = (int)L; { const int q = nwg / NXCD, r = nwg % NXCD, xcd = wgid % NXCD, off = wgid / NXCD; wgid = (xcd < r ? xcd * (q + 1) : r * (q + 1) + (xcd - r) * q) + off; }
        const int nig = WGM * nN, gid = wgid / nig, fm = gid * WGM, gsz = (nM - fm) < WGM ? (nM - fm) : WGM;
        u.pm = fm + ((wgid % nig) % gsz); u.pn = (wgid % nig) / gsz; return true;
    }
    __device__ __forceinline__ void a_ready(const Unit&) const {}
    __device__ __forceinline__ void done(const Unit&) const {}
};

__device__ __forceinline__ unsigned cvt_pk_bf16(float lo, float hi) { unsigned r; asm volatile("v_cvt_pk_bf16_f32 %0, %1, %2" : "=v"(r) : "v"(lo), "v"(hi)); return r; }
typedef float f32x2 __attribute__((ext_vector_type(2)));
__device__ __forceinline__ f32x2 gelu_pk(f32x2 v) {
    const f32x2 av = __builtin_elementwise_abs(v), d = av * 0.2316418882f + 1.0f;
    f32x2 t; t.x = __builtin_amdgcn_rcpf(d.x); t.y = __builtin_amdgcn_rcpf(d.y);
    f32x2 q = t * 0.5307027145f + (-0.7265760135f); q = q * t + 0.7107068705f; q = q * t + (-0.142248368f); q = q * t + 0.127414796f; q = q * t;
    const f32x2 s = (v * v) * (-0.72134752044f);
    f32x2 e; e.x = __builtin_amdgcn_exp2f(s.x); e.y = __builtin_amdgcn_exp2f(s.y);
    const f32x2 m = v * (q * e), r = v - m;
    f32x2 o; o.x = v.x < 0.f ? m.x : r.x; o.y = v.y < 0.f ? m.y : r.y; return o;
}

template <int ACT  > struct EpiBf16 {
    static constexpr bool PERM = true, AFTER_DRAIN = false; static_assert(ACT == 0 || ACT == 1, "EpiBf16: ACT is 0 (none) or 1 (gelu_pk)");
    bf16_t* O; int ldc; const float* bias; int split_cols; size_t split_stride; float scale0;
    __device__ __forceinline__ void operator()(const f32x4 (&acc)[2][2][4][2], const Unit& u, int wr, int wc, int fr, int fq) const {
        const int row0 = u.pm * BM + wr * 64 + fr; int colt = u.pn * BM; bf16_t* base = O;
        float sc = 1.f; if (split_cols) { const int t = colt / split_cols; base += (size_t)t * split_stride; colt -= t * split_cols; if (t == 0) sc = scale0; }
        const int col0 = colt + wc * 32 + 8 * fq, bcol0 = u.pn * BM + wc * 32 + 8 * fq;
        f32x4 bv[2][2];
#pragma unroll
        for (int bj = 0; bj < 2; ++bj)
#pragma unroll
            for (int n = 0; n < 2; ++n) bv[bj][n] = bias ? *(const f32x4*)(bias + bcol0 + bj * HALF + 4 * n) : (f32x4){0.f, 0.f, 0.f, 0.f};
#pragma unroll
        for (int ai = 0; ai < 2; ++ai)
#pragma unroll
            for (int m = 0; m < 4; ++m) { bf16_t* rowp = base + (size_t)(row0 + ai * HALF + m * 16) * ldc + col0;
#pragma unroll
                for (int bj = 0; bj < 2; ++bj) { f32x4 v0 = acc[ai][bj][m][0] + bv[bj][0], v1 = acc[ai][bj][m][1] + bv[bj][1];
                    if (ACT == 1) { f32x2 a = gelu_pk((f32x2){v0[0], v0[1]}), b = gelu_pk((f32x2){v0[2], v0[3]}), c = gelu_pk((f32x2){v1[0], v1[1]}), d = gelu_pk((f32x2){v1[2], v1[3]});
                        v0 = (f32x4){a.x, a.y, b.x, b.y}; v1 = (f32x4){c.x, c.y, d.x, d.y}; }
                    v0 = v0 * sc; v1 = v1 * sc; u32x4 w; w.x = cvt_pk_bf16(v0[0], v0[1]); w.y = cvt_pk_bf16(v0[2], v0[3]); w.z = cvt_pk_bf16(v1[0], v1[1]); w.w = cvt_pk_bf16(v1[2], v1[3]);
                    *(u32x4*)(rowp + bj * HALF) = w; } }
    }
};

struct PanelStats {
    unsigned* xbuf;
    unsigned* cnt;
    unsigned* tmo;
    int ntn; float eps;
    unsigned code;
    __device__ __forceinline__ bool run(const f32x4 (&v)[2][2][4][2], const Unit& u, int wr, int wc, int fr, int fq, PG8_LAS unsigned char* lds, int wid, int lane) const {
        typedef float f32x2v __attribute__((ext_vector_type(2)));
        PG8_LAS f32x2v* P = (PG8_LAS f32x2v*)lds;
        PG8_LAS f32x2v* S = (PG8_LAS f32x2v*)(lds + 8192);
        PG8_LAS unsigned* flag = (PG8_LAS unsigned*)(lds + 8192 + 2048);
#pragma unroll
        for (int ai = 0; ai < 2; ++ai)
#pragma unroll
            for (int m = 0; m < 4; ++m) {
                float s = 0.f;
#pragma unroll
                for (int bj = 0; bj < 2; ++bj)
#pragma unroll
                    for (int n = 0; n < 2; ++n) { const f32x4 x = v[ai][bj][m][n]; s += (x[0] + x[1]) + (x[2] + x[3]); }
                s += __shfl_xor(s, 16); s += __shfl_xor(s, 32);
                const float mw = s * (1.0f / 64.0f); float q = 0.f;
#pragma unroll
                for (int bj = 0; bj < 2; ++bj)
#pragma unroll
                    for (int n = 0; n < 2; ++n) { const f32x4 d = v[ai][bj][m][n] - mw; q += (d[0] * d[0] + d[1] * d[1]) + (d[2] * d[2] + d[3] * d[3]); }
                q += __shfl_xor(q, 16); q += __shfl_xor(q, 32);
                if (fq == 0) P[(ai * HALF + wr * 64 + m * 16 + fr) * 4 + wc] = (f32x2v){mw, q};
            }
        asm volatile("s_waitcnt lgkmcnt(0)" ::: "memory"); __builtin_amdgcn_s_barrier(); asm volatile("" ::: "memory");
#if defined(BROKEN_EXCHANGE_NO_WAIT)
#warning BROKEN CONTROL BUILD: the row-statistics exchange does not wait; results are wrong by design
        if (blockIdx.x >= 64) { const long long t0_ = clock64(); while (clock64() - t0_ < 60000) __builtin_amdgcn_s_sleep(8); }
#endif
        const int row = wid * 32 + (lane & 31);
        if (lane < 32) {
            const f32x2v a = P[row * 4 + 0], b = P[row * 4 + 1], c = P[row * 4 + 2], d = P[row * 4 + 3];
            const float mt = (a.x + b.x + c.x + d.x) * 0.25f;
            const float da = a.x - mt, db = b.x - mt, dc = c.x - mt, dd = d.x - mt;
            const float m2 = (a.y + b.y) + (c.y + d.y) + 64.0f * ((da * da + db * db) + (dc * dc + dd * dd));
            unsigned long long* slot = (unsigned long long*)xbuf + ((size_t)(u.pm * BM + row) * 4 + u.pn);
            __hip_atomic_store(slot, ((unsigned long long)__float_as_uint(m2) << 32) | __float_as_uint(mt), __ATOMIC_RELAXED, __HIP_MEMORY_SCOPE_AGENT);
        }
        asm volatile("s_waitcnt vmcnt(0)" ::: "memory");
        if (lane == 0) __hip_atomic_fetch_add(cnt + 64 * u.pm, 1u, __ATOMIC_RELAXED, __HIP_MEMORY_SCOPE_AGENT);
        if (wid == 0) {
            bool dead = false; const unsigned long long t0 = __builtin_amdgcn_s_memrealtime(); const unsigned want = 8u * (unsigned)ntn;
            for (;;) {
#if defined(BROKEN_EXCHANGE_NO_WAIT)
                break;
#endif
                if ((unsigned)__builtin_amdgcn_readfirstlane(__hip_atomic_load(cnt + 64 * u.pm, __ATOMIC_RELAXED, __HIP_MEMORY_SCOPE_AGENT)) >= want) break;
                if (__builtin_amdgcn_s_memrealtime() - t0 > 2000000ull) {
                    if (lane == 0) { unsigned expect = 0u; __hip_atomic_compare_exchange_strong(tmo + 1, &expect, code | (unsigned)(u.pm & 0xff), __ATOMIC_RELAXED, __ATOMIC_RELAXED, __HIP_MEMORY_SCOPE_AGENT);
                                     __hip_atomic_store(tmo, 1u, __ATOMIC_RELAXED, __HIP_MEMORY_SCOPE_AGENT); }
                    dead = true; break; }
                __builtin_amdgcn_s_sleep(2);
            }
            __builtin_amdgcn_fence(__ATOMIC_ACQUIRE, "agent");
            if (lane == 0) flag[0] = dead ? 1u : 0u;
        }
        asm volatile("s_waitcnt vmcnt(0) lgkmcnt(0)" ::: "memory"); __builtin_amdgcn_s_barrier(); asm volatile("" ::: "memory");
        const bool bad = flag[0] != 0u;
        if (lane < 32) {
            const unsigned long long* slot = (const unsigned long long*)xbuf + (size_t)(u.pm * BM + row) * 4; float mt[4], m2[4]; float ms = 0.f;
#pragma unroll
            for (int t = 0; t < 4; ++t) { if (t < ntn) { const unsigned long long w = __hip_atomic_load(slot + t, __ATOMIC_RELAXED, __HIP_MEMORY_SCOPE_AGENT); mt[t] = __uint_as_float((unsigned)w); m2[t] = __uint_as_float((unsigned)(w >> 32)); } else { mt[t] = 0.f; m2[t] = 0.f; } ms += mt[t]; }
            const float mean = ms / (float)ntn; float q = 0.f;
#pragma unroll
            for (int t = 0; t < 4; ++t) if (t < ntn) { const float dm = mt[t] - mean; q += m2[t] + 256.0f * dm * dm; }
            S[row] = (f32x2v){mean, 1.0f / sqrtf(q / (256.0f * (float)ntn) + eps)};
        }
        asm volatile("s_waitcnt lgkmcnt(0)" ::: "memory"); __builtin_amdgcn_s_barrier(); asm volatile("" ::: "memory");
        return bad;
    }
};
struct EpiLnRes {
    static constexpr bool PERM = false, AFTER_DRAIN = true;
    const float* base; float* out; int ldc; const float* bias; PanelStats st; unsigned poison;
    __device__ __forceinline__ void fused(f32x4 (&acc)[2][2][4][2], const Unit& u, int wr, int wc, int fr, int fq, PG8_LAS unsigned char* lds, int wid, int lane) const {
        typedef float f32x2v __attribute__((ext_vector_type(2)));
        const PG8_LAS f32x2v* S = (const PG8_LAS f32x2v*)(lds + 8192);
        const int col0 = u.pn * BM + wc * 32 + 4 * fq;
#pragma unroll
        for (int bj = 0; bj < 2; ++bj)
#pragma unroll
            for (int n = 0; n < 2; ++n) { const f32x4 bv = bias ? *(const f32x4*)(bias + col0 + bj * HALF + n * 16) : (f32x4){0.f, 0.f, 0.f, 0.f};
#pragma unroll
                for (int ai = 0; ai < 2; ++ai)
#pragma unroll
                    for (int m = 0; m < 4; ++m) acc[ai][bj][m][n] += bv; }
        f32x4 pre[4][2][2];
#pragma unroll
        for (int m = 0; m < 4; ++m) { const size_t off = (size_t)(u.pm * BM + wr * 64 + m * 16 + fr) * ldc + col0;
#pragma unroll
            for (int bj = 0; bj < 2; ++bj)
#pragma unroll
                for (int n = 0; n < 2; ++n) pre[m][bj][n] = *(const f32x4*)(base + off + bj * HALF + n * 16); }
        const bool bad = st.run(acc, u, wr, wc, fr, fq, lds, wid, lane) || poison != 0u;
        const float qnan = __builtin_nanf("");
#pragma unroll
        for (int ai = 0; ai < 2; ++ai)
#pragma unroll
            for (int m = 0; m < 4; ++m) { const int r = ai * HALF + wr * 64 + m * 16 + fr; const f32x2v sr = S[r]; const size_t off = (size_t)(u.pm * BM + r) * ldc + col0;
#pragma unroll
                for (int bj = 0; bj < 2; ++bj)
#pragma unroll
                    for (int n = 0; n < 2; ++n) { const f32x4 bs = ai == 0 ? pre[m][bj][n] : *(const f32x4*)(base + off + bj * HALF + n * 16); f32x4 o = bs + (acc[ai][bj][m][n] - sr.x) * sr.y;
                        if (bad) o = (f32x4){qnan, qnan, qnan, qnan}; *(f32x4*)(out + off + bj * HALF + n * 16) = o; }
                if (m & 1) asm volatile("" ::: "memory"); }
    }
};
struct EpiLnResLn {
    static constexpr bool PERM = false, AFTER_DRAIN = true;
    const float* base; float* out; bf16_t* xn; int ldc; const float* bias; PanelStats st1, st2; unsigned poison;
    __device__ __forceinline__ void fused(f32x4 (&acc)[2][2][4][2], const Unit& u, int wr, int wc, int fr, int fq, PG8_LAS unsigned char* lds, int wid, int lane) const {
        typedef float f32x2v __attribute__((ext_vector_type(2))); typedef unsigned u32x2v __attribute__((ext_vector_type(2)));
        const PG8_LAS f32x2v* S = (const PG8_LAS f32x2v*)(lds + 8192);
        const int col0 = u.pn * BM + wc * 32 + 4 * fq;
#pragma unroll
        for (int bj = 0; bj < 2; ++bj)
#pragma unroll
            for (int n = 0; n < 2; ++n) { const f32x4 bv = bias ? *(const f32x4*)(bias + col0 + bj * HALF + n * 16) : (f32x4){0.f, 0.f, 0.f, 0.f};
#pragma unroll
                for (int ai = 0; ai < 2; ++ai)
#pragma unroll
                    for (int m = 0; m < 4; ++m) acc[ai][bj][m][n] += bv; }
        bool bad = st1.run(acc, u, wr, wc, fr, fq, lds, wid, lane) || poison != 0u;
        const float qnan = __builtin_nanf("");
#pragma unroll
        for (int ai = 0; ai < 2; ++ai)
#pragma unroll
            for (int m = 0; m < 4; ++m) { const int r = ai * HALF + wr * 64 + m * 16 + fr; const f32x2v sr = S[r]; const size_t off = (size_t)(u.pm * BM + r) * ldc + col0;
#pragma unroll
                for (int bj = 0; bj < 2; ++bj)
#pragma unroll
                    for (int n = 0; n < 2; ++n) { const f32x4 bs = *(const f32x4*)(base + off + bj * HALF + n * 16); acc[ai][bj][m][n] = bs + (acc[ai][bj][m][n] - sr.x) * sr.y; }
                asm volatile("" : "+v"(acc[ai][0][m][0]), "+v"(acc[ai][0][m][1]), "+v"(acc[ai][1][m][0]), "+v"(acc[ai][1][m][1]));
                if (m & 1) asm volatile("" ::: "memory"); }
        const bool bad1 = bad;
        bad = st2.run(acc, u, wr, wc, fr, fq, lds, wid, lane) || bad;
#pragma unroll
        for (int ai = 0; ai < 2; ++ai)
#pragma unroll
            for (int m = 0; m < 4; ++m) { const int r = ai * HALF + wr * 64 + m * 16 + fr; const f32x2v sr = S[r]; const size_t off = (size_t)(u.pm * BM + r) * ldc + col0;
#pragma unroll
                for (int bj = 0; bj < 2; ++bj)
#pragma unroll
                    for (int n = 0; n < 2; ++n) { const f32x4 x1 = acc[ai][bj][m][n]; *(f32x4*)(out + off + bj * HALF + n * 16) = bad1 ? (f32x4){qnan, qnan, qnan, qnan} : x1;
                        const f32x4 o = (x1 - sr.x) * sr.y; u32x2v w; w.x = cvt_pk_bf16(o[0], o[1]); w.y = cvt_pk_bf16(o[2], o[3]);
                        if (bad) { w.x = 0x7fc07fc0u; w.y = 0x7fc07fc0u; } *(u32x2v*)(xn + off + bj * HALF + n * 16) = w; }
                asm volatile("" ::: "memory"); }
    }
};

template <class Epi, class Sched, bool ALIGN_EPI = false, bool SP2 = false>
__device__ __forceinline__ void gemm_phase(PG8_LAS unsigned char* lds, const Gemm g, const Sched& S, const Epi& E) {
    const int tid = threadIdx.x, wid = __builtin_amdgcn_readfirstlane(tid >> 6), lane = tid & 63, wr = wid >> 2, wc = wid & 3, fr = lane & 15, fq = lane >> 4;
    const int K = g.K, nt = K / BK;
    unsigned voffA[2], voffB[2];
#pragma unroll
    for (int i = 0; i < 2; ++i) { int R, C; stage_rc(tid * 16 + i * 8192, R, C); const int Rb = Epi::PERM ? ((R & ~31) + perm32(R & 31)) : R;
        voffA[i] = (unsigned)(R * K + C) * 2u; voffB[i] = (unsigned)(Rb * K + C) * 2u; }
    const size_t kstep = (size_t)(BK * 2);
    const size_t hstep = (size_t)HALF * K * 2;
    const size_t tstep = 2 * hstep;
    const unsigned ldsw = (unsigned)wid * 1024u;
    const int aoff = lds_byte(wr * 64 + fr, fq * 8), boff = lds_byte(wc * 32 + fr, fq * 8);
#define PG8_SA(b, h) (((b) * 2 + (h)) * HTB)
#define PG8_SB(b, h) ((4 + (b) * 2 + (h)) * HTB)
#define PG8_STAGE(bufoff, gbase, voff) do { _Pragma("unroll") for (int _i = 0; _i < 2; ++_i) \
        __builtin_amdgcn_global_load_lds((const unsigned*)((const char*)(gbase) + (voff)[_i]), (PG8_LAS unsigned*)(lds + (bufoff) + ldsw + _i * 8192), 16, 0, 0); } while (0)
#define PG8_LDA(dst, b, h) do { _Pragma("unroll") for (int m = 0; m < 4; ++m) _Pragma("unroll") for (int k = 0; k < 2; ++k) dst[m][k] = *(const PG8_LAS bf16x8*)(lds + PG8_SA(b, h) + aoff + m * 2048 + k * 1024); } while (0)
#define PG8_LDB(dst, b, h) do { _Pragma("unroll") for (int n = 0; n < 2; ++n) _Pragma("unroll") for (int k = 0; k < 2; ++k) dst[n][k] = *(const PG8_LAS bf16x8*)(lds + PG8_SB(b, h) + boff + n * 2048 + k * 1024); } while (0)
#define PG8_MMA(ai, bj, At, Bt) do { __builtin_amdgcn_s_setprio(1); _Pragma("unroll") for (int m = 0; m < 4; ++m) _Pragma("unroll") for (int n = 0; n < 2; ++n) _Pragma("unroll") for (int k = 0; k < 2; ++k) \
        acc[ai][bj][m][n] = __builtin_amdgcn_mfma_f32_16x16x32_bf16(Bt[n][k], At[m][k], acc[ai][bj][m][n], 0, 0, 0); __builtin_amdgcn_s_setprio(0); } while (0)
#define PG8_WAIT_V(n) asm volatile("s_waitcnt vmcnt(" #n ")" ::: "memory")
#define PG8_WAIT_L(n) asm volatile("s_waitcnt lgkmcnt(" #n ")" ::: "memory")
#define PG8_BAR __builtin_amdgcn_s_barrier()
#define PG8_SCHED __builtin_amdgcn_sched_barrier(0)
    Unit cur, nxt; int ui = 0;
    if (!S.next(0, cur)) return;
    f32x4 acc[2][2][4][2];
#pragma unroll
    for (int a = 0; a < 2; ++a)
#pragma unroll
        for (int b = 0; b < 2; ++b)
#pragma unroll
            for (int m = 0; m < 4; ++m)
#pragma unroll
                for (int n = 0; n < 2; ++n) acc[a][b][m][n] = (f32x4){0.f, 0.f, 0.f, 0.f};
    bf16x8 At[4][2], B0[2][2], B1[2][2];
    const char* cA = (const char*)g.A + (size_t)cur.pm * tstep; const char* cB = (const char*)g.Bt + (size_t)cur.pn * tstep;
    S.a_ready(cur);
    if constexpr (SP2) {
        PG8_STAGE(PG8_SB(0, 0), cB, voffB); PG8_STAGE(PG8_SB(0, 1), cB + hstep, voffB); PG8_STAGE(PG8_SA(0, 0), cA, voffA); PG8_STAGE(PG8_SA(0, 1), cA + hstep, voffA);
        if (wr == 1) PG8_BAR;
        PG8_WAIT_V(2); PG8_BAR;
        PG8_STAGE(PG8_SB(1, 0), cB + kstep, voffB); PG8_STAGE(PG8_SA(1, 0), cA + kstep, voffA); PG8_STAGE(PG8_SB(1, 1), cB + hstep + kstep, voffB);
        PG8_WAIT_V(6); PG8_BAR;
    } else {
        PG8_STAGE(PG8_SB(0, 0), cB, voffB); PG8_STAGE(PG8_SA(0, 0), cA, voffA); PG8_STAGE(PG8_SB(0, 1), cB + hstep, voffB); PG8_STAGE(PG8_SA(0, 1), cA + hstep, voffA);
        if (wr == 1) PG8_BAR;
        PG8_WAIT_V(4); PG8_BAR;
        PG8_STAGE(PG8_SB(1, 0), cB + kstep, voffB); PG8_STAGE(PG8_SA(1, 0), cA + kstep, voffA); PG8_STAGE(PG8_SB(1, 1), cB + hstep + kstep, voffB);
        PG8_WAIT_V(6); PG8_BAR;
    }
    for (;;) {
        const bool has_next = S.next(ui + 1, nxt);
        const char* nA = has_next ? (const char*)g.A + (size_t)nxt.pm * tstep : cA; const char* nB = has_next ? (const char*)g.Bt + (size_t)nxt.pn * tstep : cB;
        for (int t = 0; t < nt; t += 2) {
            const bool last = (t == nt - 2);
            const char* a1 = cA + (size_t)(t + 1) * kstep;
            const char* a2 = last ? nA : cA + (size_t)(t + 2) * kstep; const char* b2 = last ? nB : cB + (size_t)(t + 2) * kstep;
            const char* a3 = a2 + kstep; const char* b3 = b2 + kstep;
            if (last && has_next) S.a_ready(nxt);
            if constexpr (SP2) {
            PG8_LDB(B0, 0, 0); PG8_LDB(B1, 0, 1); PG8_SCHED; PG8_LDA(At, 0, 0); PG8_STAGE(PG8_SA(1, 1), a1 + hstep, voffA);
            PG8_WAIT_V(8); PG8_WAIT_L(0); PG8_BAR; PG8_MMA(0, 0, At, B0); PG8_MMA(0, 1, At, B1); PG8_BAR; PG8_SCHED;
            PG8_LDA(At, 0, 1); PG8_STAGE(PG8_SB(0, 0), b2, voffB); PG8_STAGE(PG8_SB(0, 1), b2 + hstep, voffB); PG8_STAGE(PG8_SA(0, 0), a2, voffA);
            PG8_WAIT_V(8); PG8_WAIT_L(0); PG8_BAR; PG8_MMA(1, 0, At, B0); PG8_MMA(1, 1, At, B1); PG8_BAR; PG8_SCHED;
            PG8_LDB(B0, 1, 0); PG8_LDB(B1, 1, 1); PG8_SCHED; PG8_LDA(At, 1, 0); PG8_STAGE(PG8_SA(0, 1), a2 + hstep, voffA);
            PG8_WAIT_V(8); PG8_WAIT_L(0); PG8_BAR; PG8_MMA(0, 0, At, B0); PG8_MMA(0, 1, At, B1); PG8_BAR; PG8_SCHED;
            PG8_LDA(At, 1, 1); PG8_STAGE(PG8_SB(1, 0), b3, voffB); PG8_STAGE(PG8_SB(1, 1), b3 + hstep, voffB); PG8_STAGE(PG8_SA(1, 0), a3, voffA);
            PG8_WAIT_V(8); PG8_WAIT_L(0); PG8_BAR; PG8_MMA(1, 0, At, B0); PG8_MMA(1, 1, At, B1); PG8_BAR; PG8_SCHED;
            } else {
            PG8_LDB(B0, 0, 0); PG8_SCHED; PG8_LDA(At, 0, 0); PG8_STAGE(PG8_SA(1, 1), a1 + hstep, voffA);
            PG8_WAIT_L(8); PG8_BAR; PG8_WAIT_L(0); PG8_MMA(0, 0, At, B0); PG8_BAR; PG8_SCHED;
            PG8_LDB(B1, 0, 1); PG8_STAGE(PG8_SB(0, 0), b2, voffB);
            PG8_BAR; PG8_WAIT_L(0); PG8_MMA(0, 1, At, B1); PG8_BAR;
            PG8_LDA(At, 0, 1); PG8_STAGE(PG8_SA(0, 0), a2, voffA);
            PG8_BAR; PG8_WAIT_L(0); PG8_MMA(1, 0, At, B0); PG8_BAR; PG8_SCHED;
            PG8_STAGE(PG8_SB(0, 1), b2 + hstep, voffB);
            PG8_WAIT_V(6); PG8_BAR; PG8_MMA(1, 1, At, B1); PG8_BAR;
            PG8_LDB(B0, 1, 0); PG8_SCHED; PG8_LDA(At, 1, 0); PG8_STAGE(PG8_SA(0, 1), a2 + hstep, voffA);
            PG8_WAIT_L(8); PG8_BAR; PG8_WAIT_L(0); PG8_MMA(0, 0, At, B0); PG8_BAR; PG8_SCHED;
            PG8_LDB(B1, 1, 1); PG8_STAGE(PG8_SB(1, 0), b3, voffB);
            PG8_BAR; PG8_WAIT_L(0); PG8_MMA(0, 1, At, B1); PG8_BAR;
            PG8_LDA(At, 1, 1); PG8_STAGE(PG8_SA(1, 0), a3, voffA);
            PG8_BAR; PG8_WAIT_L(0); PG8_MMA(1, 0, At, B0); PG8_BAR; PG8_SCHED;
            PG8_STAGE(PG8_SB(1, 1), b3 + hstep, voffB);
            PG8_WAIT_V(6); PG8_BAR; PG8_MMA(1, 1, At, B1); PG8_BAR;
            }
        }
        if constexpr (ALIGN_EPI) { if (wr == 0) PG8_BAR; }
        if constexpr (!Epi::AFTER_DRAIN) { E(acc, cur, wr, wc, fr, fq); S.done(cur); }
        if (!has_next) break;
#pragma unroll
        for (int a = 0; a < 2; ++a)
#pragma unroll
            for (int b = 0; b < 2; ++b)
#pragma unroll
                for (int m = 0; m < 4; ++m)
#pragma unroll
                    for (int n = 0; n < 2; ++n) acc[a][b][m][n] = (f32x4){0.f, 0.f, 0.f, 0.f};
        cur = nxt; cA = nA; cB = nB; ++ui;
        if constexpr (ALIGN_EPI) { if (wr == 1) PG8_BAR; }
    }
    PG8_WAIT_V(0);
    if constexpr (!ALIGN_EPI) { if (wr == 0) PG8_BAR; }
    PG8_BAR;
    if constexpr (Epi::AFTER_DRAIN) { E.fused(acc, cur, wr, wc, fr, fq, lds, wid, lane); S.done(cur); }
#undef PG8_SA
#undef PG8_SB
#undef PG8_STAGE
#undef PG8_LDA
#undef PG8_LDB
#undef PG8_MMA
#undef PG8_WAIT_V
#undef PG8_WAIT_L
#undef PG8_BAR
#undef PG8_SCHED
}
}
#define DI __device__ __forceinline__
constexpr int NWAVES = 8;
constexpr int DM = 1024, SEQ = 8192, MP = 2 * SEQ, MS = 256, MROWS = MP + MS;
constexpr int NIN = 3584, NTILE = 128;
constexpr float EPS = 1e-6f;
constexpr size_t MiB = 1u << 20;
constexpr size_t WS_CTL = 0, CTL_ZERO_BYTES = 1 * MiB;
constexpr size_t WS_WIN = 1 * MiB, WS_WOUT = 8 * MiB, WS_HN = 10 * MiB  , WS_QS = 43 * MiB, WS_VI = 60 * MiB, WS_GA = 77 * MiB, WS_UG = 94 * MiB, WS_GV = 111 * MiB;
constexpr size_t WS_LOGF = 128 * MiB, WS_UT = 161 * MiB, WS_ST = 193 * MiB, WS_D = 209 * MiB, WS_END = 210 * MiB;
constexpr size_t OUT_YS = (size_t)MP * DM, OUT_SP = (size_t)MROWS * DM, OUT_SS = OUT_SP + 2 * 4 * 128 * 128, OUT_V = OUT_SS + 16 * 4 * 128 * 128, OUT_END = OUT_V + 16 * 16 * 512;
constexpr int CW_BAR = 4096;
constexpr int LDS_BYTES = 147456, LDSCTL_OFF = LDS_BYTES - 512;
constexpr int PITCH = 272;

typedef unsigned short bf16;
typedef unsigned v4u __attribute__((ext_vector_type(4)));
typedef unsigned v2u __attribute__((ext_vector_type(2)));
typedef float f32x4 __attribute__((ext_vector_type(4)));
typedef float f32x2 __attribute__((ext_vector_type(2)));
typedef short bf16x8 __attribute__((ext_vector_type(8)));
#define GAS __attribute__((address_space(1)))
#define LAS __attribute__((address_space(3)))
typedef GAS unsigned gu32;
#define RLX_AGENT __ATOMIC_RELAXED, __HIP_MEMORY_SCOPE_AGENT
#define LDS_WAIT() asm volatile("s_waitcnt lgkmcnt(0)" ::: "memory")
#define VM_WAIT() asm volatile("s_waitcnt vmcnt(0)" ::: "memory")
DI unsigned pk2(float lo, float hi) { unsigned r; asm volatile("v_cvt_pk_bf16_f32 %0, %1, %2" : "=v"(r) : "v"(lo), "v"(hi)); return r; }
DI float bf2f(unsigned u16) { return __uint_as_float(u16 << 16); }
DI float bflo(unsigned w) { return __uint_as_float(w << 16); }
DI float bfhi(unsigned w) { return __uint_as_float(w & 0xffff0000u); }
DI float sigm(float x) { return __builtin_amdgcn_rcpf(1.0f + __expf(-x)); }
DI float wave_sum(float v) {
#pragma unroll
    for (int o = 1; o < 64; o <<= 1) v += __shfl_xor(v, o);
    return v;
}
#define XB_TMO      128
#define XB_XCNT(j)  (256  + 64 * (j))
#define XB_XSUB(j)  (1280 + 64 * (j))
#define XB_XGEN(j)  (2304 + 64 * (j))
#define XB_TOP      3328
#define XB_TOPGEN   3392
#define XCD_BAR_WORDS 3456
#define XB_SPIN_CAP (1u << 18)

__device__ __forceinline__ unsigned xb_ld(unsigned* p)              { return __hip_atomic_load(p, __ATOMIC_RELAXED, __HIP_MEMORY_SCOPE_AGENT); }
__device__ __forceinline__ unsigned xb_add(unsigned* p, unsigned v) { return __hip_atomic_fetch_add(p, v, __ATOMIC_RELAXED, __HIP_MEMORY_SCOPE_AGENT); }
__device__ __forceinline__ unsigned xb_xcc_id() { return (unsigned)__builtin_amdgcn_s_getreg((3 << 11) | 20) & 0xFu; }
#define XB_SPIN(cond, bar) do { unsigned _sp = 0; while (cond) { __builtin_amdgcn_s_sleep(1); \
    if ((++_sp & 255u) == 0u) { if (xb_ld(&(bar)[XB_TMO])) break; if (_sp > XB_SPIN_CAP) { atomicAdd(&(bar)[XB_TMO], 1u); break; } } } } while (0)

struct XcdBarrier {
    unsigned* bar; unsigned x;
    volatile LAS unsigned* st;
};

__device__ __forceinline__ XcdBarrier xcd_barrier_post(unsigned* bar, volatile LAS unsigned* st) {
    XcdBarrier b; b.bar = bar; b.x = xb_xcc_id(); b.st = st;
    if (threadIdx.x == 0) (void)xb_add(&bar[XB_XCNT(b.x)], 1u);
    return b;
}
__device__ __forceinline__ void xcd_barrier_complete(unsigned* bar, unsigned x, unsigned& nloc, unsigned& nx) {
    const unsigned G = gridDim.x * gridDim.y * gridDim.z;
    unsigned sum, cnt, mine, sp = 0u;
    for (;;) {
        sum = 0u; cnt = 0u; mine = 0u;
#pragma unroll
        for (unsigned j = 0; j < 16; ++j) { const unsigned c = xb_ld(&bar[XB_XCNT(j)]); sum += c; cnt += (c > 0u) ? 1u : 0u; mine = (j == x) ? c : mine; }
        if (sum == G) break;
        __builtin_amdgcn_s_sleep(1);
        if ((++sp & 255u) == 0u) { if (xb_ld(&bar[XB_TMO])) break; if (sp > XB_SPIN_CAP) { atomicAdd(&bar[XB_TMO], 1u); break; } }
    }
    nloc = mine > 0u ? mine : 1u; nx = cnt > 0u ? cnt : 1u;
}

__device__ __forceinline__ void xcd_barrier(const XcdBarrier& b) {
    asm volatile("s_waitcnt vmcnt(0)" ::: "memory");
    __syncthreads();
    if (threadIdx.x == 0) {
        unsigned* bar = b.bar;
        __builtin_amdgcn_s_waitcnt(0);
        unsigned nloc = b.st[0], nx = b.st[1];
        if (nloc == 0u) { xcd_barrier_complete(bar, b.x, nloc, nx); b.st[0] = nloc; b.st[1] = nx; }
        const unsigned old = xb_add(&bar[XB_XSUB(b.x)], 1u);
        const unsigned gen = old / nloc;
        if (old + 1u == (gen + 1u) * nloc) {
            __builtin_amdgcn_fence(__ATOMIC_RELEASE, "agent");
            asm volatile("s_waitcnt vmcnt(0)" ::: "memory");
            const unsigned og = xb_add(&bar[XB_TOP], 1u);
            const unsigned tg = og / nx;
            if (og + 1u == (tg + 1u) * nx) xb_add(&bar[XB_TOPGEN], 1u);
            else XB_SPIN(xb_ld(&bar[XB_TOPGEN]) == tg, bar);
            __builtin_amdgcn_fence(__ATOMIC_ACQUIRE, "agent");
            xb_add(&bar[XB_XGEN(b.x)], 1u);
            asm volatile("s_waitcnt vmcnt(0)" ::: "memory");
        } else {
            XB_SPIN(xb_ld(&bar[XB_XGEN(b.x)]) == gen, bar);
            __builtin_amdgcn_fence(__ATOMIC_ACQUIRE, "agent");
            asm volatile("s_waitcnt vmcnt(0)" ::: "memory");
        }
    }
    __syncthreads();
}
struct EpiIn {
    static constexpr bool PERM = true, AFTER_DRAIN = false;
    bf16 *QS, *VI, *GA, *UG, *GV; float* LOGF; const float* lbl;
    DI void operator()(const pg8::f32x4 (&acc)[2][2][4][2], const pg8::Unit& u, int wr, int wc, int fr, int fq) const {
        const int row0 = u.pm * 256 + wr * 64 + fr, cc = wc * 32 + 8 * fq, pn = u.pn;
        if (pn < 4) {
            const int col = pn * 128 + cc;
            float lb[8];
            { const f32x4 a0 = *(const f32x4*)(lbl + col), a1 = *(const f32x4*)(lbl + col + 4), b0 = *(const f32x4*)(lbl + 512 + col), b1 = *(const f32x4*)(lbl + 512 + col + 4);
#pragma unroll
              for (int j = 0; j < 4; ++j) { lb[j] = __builtin_amdgcn_rcpf(1.0f + __expf(b0[j] - a0[j])); lb[4 + j] = __builtin_amdgcn_rcpf(1.0f + __expf(b1[j] - a1[j])); } }
#pragma unroll
            for (int ai = 0; ai < 2; ++ai)
#pragma unroll
                for (int m = 0; m < 4; ++m) {
                    const size_t o = (size_t)(row0 + ai * 128 + m * 16) * 512 + col;
                    float q[8], lg[8];
#pragma unroll
                    for (int j = 0; j < 8; ++j) { const float x = acc[ai][0][m][j >> 2][j & 3]; q[j] = x * sigm(x) * 0.08838834764831845f;
                        const float fr_ = acc[ai][1][m][j >> 2][j & 3]; const float f = lb[j] + (1.0f - lb[j]) * sigm(fr_); lg[j] = __logf(f); }
                    v4u w; w.x = pk2(q[0], q[1]); w.y = pk2(q[2], q[3]); w.z = pk2(q[4], q[5]); w.w = pk2(q[6], q[7]);
                    *(v4u*)(QS + o) = w;
                    *(f32x4*)(LOGF + o) = (f32x4){lg[0], lg[1], lg[2], lg[3]}; *(f32x4*)(LOGF + o + 4) = (f32x4){lg[4], lg[5], lg[6], lg[7]};
                }
        } else if (pn < 8) {
            const int col = (pn - 4) * 128 + cc;
#pragma unroll
            for (int ai = 0; ai < 2; ++ai)
#pragma unroll
                for (int m = 0; m < 4; ++m) {
                    const size_t o = (size_t)(row0 + ai * 128 + m * 16) * 512 + col;
                    float a[8], g[8];
#pragma unroll
                    for (int j = 0; j < 8; ++j) { a[j] = acc[ai][0][m][j >> 2][j & 3]; const float x = acc[ai][1][m][j >> 2][j & 3]; g[j] = x * sigm(x); }
                    v4u w; w.x = pk2(a[0], a[1]); w.y = pk2(a[2], a[3]); w.z = pk2(a[4], a[5]); w.w = pk2(a[6], a[7]);
                    *(v4u*)(VI + o) = w;
                    w.x = pk2(g[0], g[1]); w.y = pk2(g[2], g[3]); w.z = pk2(g[4], g[5]); w.w = pk2(g[6], g[7]);
                    *(v4u*)(GA + o) = w;
                }
        } else if (pn < 12) {
            const int col = (pn - 8) * 128 + cc;
#pragma unroll
            for (int ai = 0; ai < 2; ++ai)
#pragma unroll
                for (int m = 0; m < 4; ++m) {
                    const size_t o = (size_t)(row0 + ai * 128 + m * 16) * 512 + col;
                    float a[8];
#pragma unroll
                    for (int j = 0; j < 8; j += 2) { const pg8::f32x2 gu = pg8::gelu_pk((pg8::f32x2){acc[ai][0][m][j >> 2][j & 3], acc[ai][0][m][j >> 2][(j & 3) + 1]});
                        const float x0 = acc[ai][1][m][j >> 2][j & 3], x1 = acc[ai][1][m][j >> 2][(j & 3) + 1];
                        a[j] = gu.x * (x0 * sigm(x0)); a[j + 1] = gu.y * (x1 * sigm(x1)); }
                    v4u w; w.x = pk2(a[0], a[1]); w.y = pk2(a[2], a[3]); w.z = pk2(a[4], a[5]); w.w = pk2(a[6], a[7]);
                    *(v4u*)(UG + o) = w;
                }
        } else {
            const int col = (pn - 12) * 256 + cc;
#pragma unroll
            for (int ai = 0; ai < 2; ++ai)
#pragma unroll
                for (int m = 0; m < 4; ++m)
#pragma unroll
                    for (int bj = 0; bj < 2; ++bj) {
                        const size_t o = (size_t)(row0 + ai * 128 + m * 16) * 512 + col + bj * 128;
                        float a[8];
#pragma unroll
                        for (int j = 0; j < 8; j += 2) { const pg8::f32x2 gu = pg8::gelu_pk((pg8::f32x2){acc[ai][bj][m][j >> 2][j & 3], acc[ai][bj][m][j >> 2][(j & 3) + 1]}); a[j] = gu.x; a[j + 1] = gu.y; }
                        v4u w; w.x = pk2(a[0], a[1]); w.y = pk2(a[2], a[3]); w.z = pk2(a[4], a[5]); w.w = pk2(a[6], a[7]);
                        *(v4u*)(GV + o) = w;
                    }
        }
    }
};
struct EpiOutPre {
    static constexpr bool PERM = false, AFTER_DRAIN = false;
    const float* xp; const float* xs; float* out;
    DI void operator()(const pg8::f32x4 (&acc)[2][2][4][2], const pg8::Unit& u, int wr, int wc, int fr, int fq) const {
        const int row0 = u.pm * 256 + wr * 64 + fr, col0 = u.pn * 256 + wc * 32 + 4 * fq;
        const float* xb = (u.pm < 64) ? xp : (xs - (size_t)MP * DM);
#pragma unroll
        for (int ai = 0; ai < 2; ++ai)
#pragma unroll
            for (int m = 0; m < 4; ++m) { const size_t o = (size_t)(row0 + ai * 128 + m * 16) * DM + col0;
#pragma unroll
                for (int bj = 0; bj < 2; ++bj)
#pragma unroll
                    for (int n = 0; n < 2; ++n) *(f32x4*)(out + o + bj * 128 + n * 16) = *(const f32x4*)(xb + o + bj * 128 + n * 16) + acc[ai][bj][m][n]; }
    }
};
DI int colmap(int np) {
    const int pn = np >> 8, j = np & 255, half = j >> 7, c = j & 127;
    if (pn < 4) return (half ? 512 : 0) + pn * 128 + c;
    if (pn < 8) return (half ? 1536 : 1024) + (pn - 4) * 128 + c;
    if (pn < 12) return (half ? 3072 : 2048) + (pn - 8) * 128 + c;
    return 2560 + (pn - 12) * 256 + j;
}
DI void p0_transpose_item(const float* W, int K, int N, bf16* WT, int e0, int n0, int k0, LAS float* scr, int lane) {
#pragma unroll 8
    for (int i = 0; i < 32; ++i) { const int kk = 2 * i + (lane >> 5); scr[kk * 33 + (lane & 31)] = W[(size_t)(k0 + kk) * N + e0 + (lane & 31)]; }
    LDS_WAIT(); asm volatile("" ::: "memory");
    const int c = lane & 7;
#pragma unroll
    for (int j = 0; j < 4; ++j) { const int n = (lane >> 3) + 8 * j; const LAS float* s = scr + (8 * c) * 33 + n;
        v4u o; o.x = pk2(s[0 * 33], s[1 * 33]); o.y = pk2(s[2 * 33], s[3 * 33]); o.z = pk2(s[4 * 33], s[5 * 33]); o.w = pk2(s[6 * 33], s[7 * 33]);
        *(GAS v4u*)(WT + (size_t)(n0 + n) * K + k0 + 8 * c) = o; }
    LDS_WAIT(); asm volatile("" ::: "memory");
}
DI void p0_prologue(LAS unsigned char* lds, const float* xp, const float* xs, const float* normw, const float* w_in, const float* w_out, bf16* WIN_T, bf16* WOUT_T, bf16* HN, int vcu, int G, int wave, int lane) {
    LAS float* scr = (LAS float*)(lds + wave * 16384);
    const int gw = vcu * NWAVES + wave, NGW = G * NWAVES;
    constexpr int I_IN = (DM / 64) * (NIN / 32), I_OUT = (DM / 64) * (DM / 32);
    for (int it = gw; it < I_IN + I_OUT; it += NGW) {
        if (it < I_IN) { const int kb = it / (NIN / 32), nb = it % (NIN / 32); p0_transpose_item(w_in, DM, NIN, WIN_T, colmap(32 * nb), 32 * nb, 64 * kb, scr, lane); }
        else { const int r = it - I_IN, kb = r / (DM / 32), nb = r % (DM / 32); p0_transpose_item(w_out, DM, DM, WOUT_T, 32 * nb, 32 * nb, 64 * kb, scr, lane); }
    }
    for (int m = gw; m < MROWS; m += NGW) {
        const float* xrow = (m < MP) ? xp + (size_t)m * DM : xs + (size_t)(m - MP) * DM;
        const GAS f32x4* xr = (const GAS f32x4*)xrow + lane; const GAS f32x4* nw = (const GAS f32x4*)normw + lane;
        f32x4 v[4]; float s = 0.f;
#pragma unroll
        for (int j = 0; j < 4; ++j) { v[j] = xr[64 * j]; s += (v[j].x * v[j].x + v[j].y * v[j].y) + (v[j].z * v[j].z + v[j].w * v[j].w); }
        const float rstd = rsqrtf(wave_sum(s) * (1.f / DM) + EPS);
        GAS v2u* o8 = (GAS v2u*)(HN + (size_t)m * DM) + lane;
#pragma unroll
        for (int j = 0; j < 4; ++j) { const f32x4 w = nw[64 * j]; v2u o; o.x = pk2(v[j].x * rstd * w.x, v[j].y * rstd * w.y); o.y = pk2(v[j].z * rstd * w.z, v[j].w * rstd * w.w); o8[64 * j] = o; }
    }
}

DI void tile_cumsum(const float* LOGF, int r0, int hoff, LAS float* tot, float (&lf)[32], float (&b)[32], float& b63, float& bend, int tid) {
    const int k = tid & 127, tq = tid >> 7;
    const float* p = LOGF + (size_t)(r0 + 32 * tq) * 512 + hoff + k;
#pragma unroll
    for (int i = 0; i < 32; ++i) lf[i] = p[(size_t)i * 512];
    float run = 0.f;
#pragma unroll
    for (int i = 0; i < 32; ++i) { run += lf[i]; b[i] = run; }
    tot[tq * 128 + k] = run;
    __syncthreads();
    const float t0 = tot[k], t1 = tot[128 + k], t2 = tot[256 + k], t3 = tot[384 + k];
    const float off = (tq > 0 ? t0 : 0.f) + (tq > 1 ? t1 : 0.f) + (tq > 2 ? t2 : 0.f);
#pragma unroll
    for (int i = 0; i < 32; ++i) b[i] += off;
    b63 = t0 + t1; bend = (t0 + t1) + (t2 + t3);
}
DI void load_vt(const bf16* V, int r0, int hoff, LAS unsigned char* VT, int tid) {
    const int v = tid & 127, tq = tid >> 7;
    const bf16* p = V + (size_t)(r0 + 32 * tq) * 512 + hoff + v;
    unsigned x[32];
#pragma unroll
    for (int i = 0; i < 32; ++i) x[i] = p[(size_t)i * 512];
#pragma unroll
    for (int c = 0; c < 4; ++c) { v4u w; w.x = x[8 * c] | (x[8 * c + 1] << 16); w.y = x[8 * c + 2] | (x[8 * c + 3] << 16); w.z = x[8 * c + 4] | (x[8 * c + 5] << 16); w.w = x[8 * c + 6] | (x[8 * c + 7] << 16);
        *(LAS v4u*)(VT + v * PITCH + (32 * tq + 8 * c) * 2) = w; }
}
#define FRAG(base, row, ks) (*(const LAS bf16x8*)((base) + (row) * PITCH + ((ks) * 32 + 8 * fq) * 2))
#define MFMA16(a, b, c) __builtin_amdgcn_mfma_f32_16x16x32_bf16((a), (b), (c), 0, 0, 0)

DI void p2_item(LAS unsigned char* lds, const float* LOGF, const bf16* VI, float* UT, float* D, int n, int h, int tid, int wave, int lane) {
    LAS unsigned char* KDT = lds; LAS unsigned char* VT = lds + 34816; LAS float* tot = (LAS float*)(lds + 69632);
    const int r0 = n * 128, hoff = h * 128, k = tid & 127, tq = tid >> 7, fr = lane & 15, fq = lane >> 4;
    float lf[32], b[32], b63, bend;
    tile_cumsum(LOGF, r0, hoff, tot, lf, b, b63, bend, tid);
#pragma unroll
    for (int c = 0; c < 4; ++c) { float kd[8];
#pragma unroll
        for (int j = 0; j < 8; ++j) kd[j] = (1.0f - __expf(lf[8 * c + j])) * __expf(bend - b[8 * c + j]);
        v4u w; w.x = pk2(kd[0], kd[1]); w.y = pk2(kd[2], kd[3]); w.z = pk2(kd[4], kd[5]); w.w = pk2(kd[6], kd[7]);
        *(LAS v4u*)(KDT + k * PITCH + (32 * tq + 8 * c) * 2) = w; }
    load_vt(VI, r0, hoff, VT, tid);
    if (tq == 0) D[(size_t)(n * 4 + h) * 128 + k] = __expf(bend);
    __syncthreads();
    bf16x8 a[4];
#pragma unroll
    for (int ks = 0; ks < 4; ++ks) a[ks] = FRAG(VT, 16 * wave + fr, ks);
    float* up = UT + ((size_t)(n * 4 + h) * 128 + 16 * wave + fr) * 128 + 4 * fq;
#pragma unroll
    for (int c = 0; c < 8; ++c) { f32x4 acc = {0.f, 0.f, 0.f, 0.f};
#pragma unroll
        for (int ks = 0; ks < 4; ++ks) acc = MFMA16(FRAG(KDT, 16 * c + fr, ks), a[ks], acc);
        *(f32x4*)(up + 16 * c) = acc; }
    __syncthreads();
}

DI void p3_scan(const float* UT, const float* D, bf16* ST, float* out_sp, int gtid, int gthreads) {
    for (int p = gtid; p < 8 * 16384; p += gthreads) {
        const int bh = p >> 14, e = p & 16383, bb = bh >> 2, h = bh & 3, k = e & 127, v = e >> 7;
        float s = 0.f;
#pragma unroll 8
        for (int j = 0; j < 64; ++j) { const size_t base = (size_t)((bb * 64 + j) * 4 + h);
            const float u = UT[base * 16384 + e], d = D[base * 128 + k];
            ST[base * 16384 + e] = (bf16)(pk2(s, s) & 0xffffu);
            s = d * s + u; }
        out_sp[((size_t)bh * 128 + k) * 128 + v] = s;
    }
}

DI void p4a_item(LAS unsigned char* lds, const float* LOGF, const bf16* QS, const bf16* VI, const bf16* GA, const bf16* ST, const float* gnw, bf16* Y, int n, int h, int tid, int wave, int lane) {
    LAS unsigned char* QE = lds; LAS unsigned char* KE = lds + 34816; LAS unsigned char* VT = lds + 69632; LAS unsigned char* STP = lds + 104448;
    LAS float* tot = (LAS float*)(lds + 139264); LAS float* bref = (LAS float*)(lds + 141312);
    const int r0 = n * 128, hoff = h * 128, k = tid & 127, tq = tid >> 7, fr = lane & 15, fq = lane >> 4;
    {
        float lf[32], b[32], b63, bend;
        tile_cumsum(LOGF, r0, hoff, tot, lf, b, b63, bend, tid);
        const bf16* qp = QS + (size_t)(r0 + 32 * tq) * 512 + hoff + k;
#pragma unroll
        for (int i = 0; i < 32; ++i) { const float q = bf2f(qp[(size_t)i * 512]); const float d = b[i] - b63;
            const unsigned short qe = (unsigned short)(pk2(q * __expf(d), 0.f) & 0xffffu), ke = (unsigned short)(pk2((1.0f - __expf(lf[i])) * __expf(-d), 0.f) & 0xffffu);
            *(LAS unsigned short*)(QE + (32 * tq + i) * PITCH + 2 * k) = qe; *(LAS unsigned short*)(KE + (32 * tq + i) * PITCH + 2 * k) = ke; }
        if (tq == 0) bref[k] = b63;
    }
    load_vt(VI, r0, hoff, VT, tid);
    __syncthreads();
    {
        const int c8 = tid & 15; float e[8];
#pragma unroll
        for (int j = 0; j < 8; ++j) e[j] = __expf(bref[8 * c8 + j]);
#pragma unroll
        for (int i = 0; i < 4; ++i) { const int v = (tid >> 4) + 32 * i; const v4u s = *(const v4u*)(ST + ((size_t)(n * 4 + h) * 128 + v) * 128 + 8 * c8);
            v4u w; w.x = pk2(bflo(s.x) * e[0], bfhi(s.x) * e[1]); w.y = pk2(bflo(s.y) * e[2], bfhi(s.y) * e[3]); w.z = pk2(bflo(s.z) * e[4], bfhi(s.z) * e[5]); w.w = pk2(bflo(s.w) * e[6], bfhi(s.w) * e[7]);
            *(LAS v4u*)(STP + v * PITCH + 16 * c8) = w; }
    }
    bf16x8 qa[4];
#pragma unroll
    for (int ks = 0; ks < 4; ++ks) qa[ks] = FRAG(QE, 16 * wave + fr, ks);
    f32x4 p[8];
#pragma unroll
    for (int c = 0; c < 8; ++c) { p[c] = (f32x4){0.f, 0.f, 0.f, 0.f};
        if (c <= wave) {
#pragma unroll
            for (int ks = 0; ks < 4; ++ks) p[c] = MFMA16(FRAG(KE, 16 * c + fr, ks), qa[ks], p[c]);
            if (c == wave) {
#pragma unroll
                for (int i = 0; i < 4; ++i) if (4 * fq + i > fr) p[c][i] = 0.f; } } }
    __syncthreads();
    LAS unsigned char* PM = KE;
#pragma unroll
    for (int c = 0; c < 8; ++c) { v2u w; w.x = pk2(p[c][0], p[c][1]); w.y = pk2(p[c][2], p[c][3]); *(LAS v2u*)(PM + (16 * wave + fr) * PITCH + (16 * c + 4 * fq) * 2) = w; }
    __syncthreads();
    f32x4 o[8];
#pragma unroll
    for (int c = 0; c < 8; ++c) o[c] = (f32x4){0.f, 0.f, 0.f, 0.f};
#pragma unroll
    for (int ks = 0; ks < 4; ++ks) {
        if (2 * ks <= wave) { const bf16x8 pa = FRAG(PM, 16 * wave + fr, ks);
#pragma unroll
            for (int c = 0; c < 8; ++c) o[c] = MFMA16(FRAG(VT, 16 * c + fr, ks), pa, o[c]); }
#pragma unroll
        for (int c = 0; c < 8; ++c) o[c] = MFMA16(FRAG(STP, 16 * c + fr, ks), qa[ks], o[c]);
    }
    float ss = 0.f;
#pragma unroll
    for (int c = 0; c < 8; ++c) ss += (o[c][0] * o[c][0] + o[c][1] * o[c][1]) + (o[c][2] * o[c][2] + o[c][3] * o[c][3]);
    ss += __shfl_xor(ss, 16); ss += __shfl_xor(ss, 32);
    const float rstd = rsqrtf(ss * (1.f / 128.f) + EPS);
    const size_t row = (size_t)(r0 + 16 * wave + fr);
#pragma unroll
    for (int c = 0; c < 8; ++c) { const int col = hoff + 16 * c + 4 * fq; const f32x4 gw = *(const f32x4*)(gnw + col); const v2u ga = *(const v2u*)(GA + row * 512 + col);
        v2u w; w.x = pk2(o[c][0] * rstd * gw[0] * bflo(ga.x), o[c][1] * rstd * gw[1] * bfhi(ga.x)); w.y = pk2(o[c][2] * rstd * gw[2] * bflo(ga.y), o[c][3] * rstd * gw[3] * bfhi(ga.y));
        *(v2u*)(Y + row * DM + col) = w; }
    __syncthreads();
}

DI void p4b_item(LAS unsigned char* lds, const bf16* GV, const bf16* UG, const float* lnw, const float* lnb, const float* w_s, const float* b_s, bf16* Y, int n, int g, int tid, int wave, int lane) {
    LAS unsigned char* WM = lds; LAS unsigned char* VNT = lds + 34816; LAS float* mu = (LAS float*)(lds + 69632); LAS float* rs = mu + 128;
    const int r0 = n * 128, goff = g * 128, fr = lane & 15, fq = lane >> 4;
    {
        v4u x[16];
#pragma unroll
        for (int i = 0; i < 16; ++i) x[i] = *(const v4u*)(GV + (size_t)(r0 + 16 * wave + i) * 512 + 8 * lane);
#pragma unroll
        for (int i = 0; i < 16; ++i) {
            const float a0 = bflo(x[i].x), a1 = bfhi(x[i].x), a2 = bflo(x[i].y), a3 = bfhi(x[i].y), a4 = bflo(x[i].z), a5 = bfhi(x[i].z), a6 = bflo(x[i].w), a7 = bfhi(x[i].w);
            const float s = wave_sum(((a0 + a1) + (a2 + a3)) + ((a4 + a5) + (a6 + a7)));
            const float m_ = s * (1.f / 512.f);
            const float d0 = a0 - m_, d1 = a1 - m_, d2 = a2 - m_, d3 = a3 - m_, d4 = a4 - m_, d5 = a5 - m_, d6 = a6 - m_, d7 = a7 - m_;
            const float q = wave_sum(((d0 * d0 + d1 * d1) + (d2 * d2 + d3 * d3)) + ((d4 * d4 + d5 * d5) + (d6 * d6 + d7 * d7)));
            if (lane == 0) { mu[16 * wave + i] = m_; rs[16 * wave + i] = rsqrtf(q * (1.f / 512.f) + EPS); } }
    }
    {
        const int c8 = tid & 15;
#pragma unroll
        for (int i = 0; i < 4; ++i) { const int t = (tid >> 4) + 32 * i; const float* wp = w_s + ((size_t)g * 128 + t) * 128 + 8 * c8; const f32x4 a = *(const f32x4*)wp, b = *(const f32x4*)(wp + 4);
            float x[8] = {a[0], a[1], a[2], a[3], b[0], b[1], b[2], b[3]};
#pragma unroll
            for (int j = 0; j < 8; ++j) if (8 * c8 + j > t) x[j] = 0.f;
            v4u w; w.x = pk2(x[0], x[1]); w.y = pk2(x[2], x[3]); w.z = pk2(x[4], x[5]); w.w = pk2(x[6], x[7]);
            *(LAS v4u*)(WM + t * PITCH + 16 * c8) = w; }
    }
    __syncthreads();
    {
        const int c = tid & 127, tq = tid >> 7; const float lw = lnw[goff + c], lb_ = lnb[goff + c];
        const bf16* p = GV + (size_t)(r0 + 32 * tq) * 512 + goff + c;
        float x[32];
#pragma unroll
        for (int i = 0; i < 32; ++i) x[i] = bf2f(p[(size_t)i * 512]);
#pragma unroll
        for (int i = 0; i < 32; ++i) x[i] = (x[i] - mu[32 * tq + i]) * rs[32 * tq + i] * lw + lb_;
#pragma unroll
        for (int q = 0; q < 4; ++q) { v4u w; w.x = pk2(x[8 * q], x[8 * q + 1]); w.y = pk2(x[8 * q + 2], x[8 * q + 3]); w.z = pk2(x[8 * q + 4], x[8 * q + 5]); w.w = pk2(x[8 * q + 6], x[8 * q + 7]);
            *(LAS v4u*)(VNT + c * PITCH + (32 * tq + 8 * q) * 2) = w; }
    }
    __syncthreads();
    f32x4 o[8];
#pragma unroll
    for (int c = 0; c < 8; ++c) o[c] = (f32x4){0.f, 0.f, 0.f, 0.f};
#pragma unroll
    for (int ks = 0; ks < 4; ++ks)
        if (2 * ks <= wave) { const bf16x8 wa = FRAG(WM, 16 * wave + fr, ks);
#pragma unroll
            for (int c = 0; c < 8; ++c) o[c] = MFMA16(FRAG(VNT, 16 * c + fr, ks), wa, o[c]); }
    const int t = 16 * wave + fr; const size_t row = (size_t)(r0 + t); const float bias = b_s[g * 128 + t];
#pragma unroll
    for (int c = 0; c < 8; ++c) { const int col = goff + 16 * c + 4 * fq; const v2u ug = *(const v2u*)(UG + row * 512 + col);
        v2u w; w.x = pk2(bflo(ug.x) * (o[c][0] + bias), bfhi(ug.x) * (o[c][1] + bias)); w.y = pk2(bflo(ug.y) * (o[c][2] + bias), bfhi(ug.y) * (o[c][3] + bias));
        *(v2u*)(Y + row * DM + 512 + col) = w; }
    __syncthreads();
}

DI void p4c_item(LAS unsigned char* lds, const float* LOGF, const bf16* QS, const bf16* VI, const bf16* GA, const float* S0, const float* gnw, bf16* Y, float* out_ss, int sb, int h, int tid) {
    LAS float* fv = (LAS float*)lds; LAS float* kv = fv + 2048; LAS float* qv = kv + 2048; LAS float* iv = qv + 2048; LAS float* part = iv + 2048;
    const int r0 = MP + sb * 16, hoff = h * 128;
#pragma unroll
    for (int j = 0; j < 4; ++j) { const int idx = tid + 512 * j, t = idx >> 7, k = idx & 127; const size_t o = (size_t)(r0 + t) * 512 + hoff + k;
        const float f = __expf(LOGF[o]); fv[idx] = f; kv[idx] = 1.0f - f; qv[idx] = bf2f(QS[o]); iv[idx] = bf2f(VI[o]); }
    const int v = tid & 127, kq = tid >> 7;
    float S[32];
    const float* sp = S0 + ((size_t)(sb * 4 + h) * 128 + 32 * kq) * 128 + v;
#pragma unroll
    for (int j = 0; j < 32; ++j) S[j] = sp[j * 128];
    __syncthreads();
#pragma unroll 1
    for (int t = 0; t < 16; ++t) { const float it_ = iv[t * 128 + v]; float acc = 0.f;
#pragma unroll
        for (int j = 0; j < 32; ++j) { const int k = 32 * kq + j; S[j] = fv[t * 128 + k] * S[j] + kv[t * 128 + k] * it_; acc += qv[t * 128 + k] * S[j]; }
        part[(t * 4 + kq) * 128 + v] = acc; }
    float* op = out_ss + ((size_t)(sb * 4 + h) * 128 + 32 * kq) * 128 + v;
#pragma unroll
    for (int j = 0; j < 32; ++j) op[j * 128] = S[j];
    __syncthreads();
    {   const int t = tid >> 5, vg = tid & 31; float o[4]; float ss = 0.f;
#pragma unroll
        for (int i = 0; i < 4; ++i) { const int vv = 4 * vg + i; o[i] = (part[(t * 4 + 0) * 128 + vv] + part[(t * 4 + 1) * 128 + vv]) + (part[(t * 4 + 2) * 128 + vv] + part[(t * 4 + 3) * 128 + vv]); ss += o[i] * o[i]; }
#pragma unroll
        for (int m = 1; m < 32; m <<= 1) ss += __shfl_xor(ss, m);
        const float rstd = rsqrtf(ss * (1.f / 128.f) + EPS); const size_t row = (size_t)(r0 + t); const int col = hoff + 4 * vg;
        const f32x4 gw = *(const f32x4*)(gnw + col); const v2u ga = *(const v2u*)(GA + row * 512 + col);
        v2u w; w.x = pk2(o[0] * rstd * gw[0] * bflo(ga.x), o[1] * rstd * gw[1] * bfhi(ga.x)); w.y = pk2(o[2] * rstd * gw[2] * bflo(ga.y), o[3] * rstd * gw[3] * bfhi(ga.y));
        *(v2u*)(Y + row * DM + col) = w; }
    __syncthreads();
}
DI void p4d_item(LAS unsigned char* lds, const bf16* GV, const bf16* UG, const float* lnw, const float* lnb, const float* w_s, const float* b_s, bf16* Y, float* out_v, int sb, int tid, int wave, int lane) {
    LAS float* mu = (LAS float*)lds; LAS float* rs = mu + 16;
    const int r0 = MP + sb * 16;
#pragma unroll
    for (int i = 0; i < 2; ++i) { const int t = 2 * wave + i; const v4u x = *(const v4u*)(GV + (size_t)(r0 + t) * 512 + 8 * lane);
        const float a0 = bflo(x.x), a1 = bfhi(x.x), a2 = bflo(x.y), a3 = bfhi(x.y), a4 = bflo(x.z), a5 = bfhi(x.z), a6 = bflo(x.w), a7 = bfhi(x.w);
        const float m_ = wave_sum(((a0 + a1) + (a2 + a3)) + ((a4 + a5) + (a6 + a7))) * (1.f / 512.f);
        const float d0 = a0 - m_, d1 = a1 - m_, d2 = a2 - m_, d3 = a3 - m_, d4 = a4 - m_, d5 = a5 - m_, d6 = a6 - m_, d7 = a7 - m_;
        const float q = wave_sum(((d0 * d0 + d1 * d1) + (d2 * d2 + d3 * d3)) + ((d4 * d4 + d5 * d5) + (d6 * d6 + d7 * d7)));
        if (lane == 0) { mu[t] = m_; rs[t] = rsqrtf(q * (1.f / 512.f) + EPS); } }
    __syncthreads();
    const int c = tid, g = __builtin_amdgcn_readfirstlane(tid >> 7); const float lw = lnw[c], lb_ = lnb[c];
    float vn[16];
#pragma unroll
    for (int t = 0; t < 16; ++t) { vn[t] = (bf2f(GV[(size_t)(r0 + t) * 512 + c]) - mu[t]) * rs[t] * lw + lb_; out_v[(size_t)(sb * 16 + t) * 512 + c] = vn[t]; }
#pragma unroll
    for (int t = 0; t < 16; ++t) { float m_ = b_s[g * 128 + t];
#pragma unroll
        for (int s = 0; s <= t; ++s) m_ += w_s[((size_t)g * 128 + t) * 128 + s] * vn[s];
        const float ug = bf2f(UG[(size_t)(r0 + t) * 512 + c]);
        Y[(size_t)(r0 + t) * DM + 512 + c] = (bf16)(pk2(ug * m_, 0.f) & 0xffffu); }
    __syncthreads();
}
DI void p6_final(float* out, const float* fnw, int gw, int NGW, int lane) {
    for (int m = gw; m < MROWS; m += NGW) {
        GAS f32x4* xr = (GAS f32x4*)(out + (size_t)m * DM) + lane; const GAS f32x4* nw = (const GAS f32x4*)fnw + lane;
        f32x4 v[4]; float s = 0.f;
#pragma unroll
        for (int j = 0; j < 4; ++j) { v[j] = xr[64 * j]; s += (v[j].x * v[j].x + v[j].y * v[j].y) + (v[j].z * v[j].z + v[j].w * v[j].w); }
        const float rstd = rsqrtf(wave_sum(s) * (1.f / DM) + EPS);
#pragma unroll
        for (int j = 0; j < 4; ++j) xr[64 * j] = v[j] * rstd * nw[64 * j];
    }
}
#ifndef MK_N_LAUNCHES
#define MK_N_LAUNCHES 7
#endif
constexpr int N_PHASES = 7, N_LAUNCHES = MK_N_LAUNCHES;
struct Args { const float* in[13]; float* out; unsigned char* ws; int ph_lo, ph_hi; };
static_assert(sizeof(Args) == 13 * 8 + 8 + 8 + 8, "Args has no padding bytes");
__global__ void __launch_bounds__(NWAVES * 64, 2) fwd_kernel(Args args) {
    extern __shared__ __attribute__((aligned(16))) unsigned char lds_raw[];
    LAS unsigned char* lds = (LAS unsigned char*)lds_raw;
    volatile LAS unsigned* MISC = (volatile LAS unsigned*)(lds + LDSCTL_OFF);
    const int tid = threadIdx.x, lane = tid & 63, wave = __builtin_amdgcn_readfirstlane(tid >> 6);
    const int G = gridDim.x, bx = blockIdx.x, vcu = (G % 8 == 0) ? (bx % 8) * (G / 8) + bx / 8 : bx;
    unsigned char* ws = args.ws;
    gu32* ctl = (gu32*)(ws + WS_CTL);
    const float* x_prompt = args.in[0]; const float* x_sample = args.in[1]; const float* state0 = args.in[2]; const float* norm_w = args.in[3]; const float* w_in = args.in[4];
    const float* lb_logits = args.in[5]; const float* g_norm_w = args.in[6]; const float* ln_v_w = args.in[7]; const float* ln_v_b = args.in[8]; const float* w_s = args.in[9];
    const float* b_s = args.in[10]; const float* w_out = args.in[11]; const float* final_norm_w = args.in[12];
    float* out = args.out;
    bf16* WIN_T = (bf16*)(ws + WS_WIN); bf16* WOUT_T = (bf16*)(ws + WS_WOUT); bf16* HN = (bf16*)(ws + WS_HN); bf16* Y = (bf16*)(ws + WS_HN);
    bf16* QS = (bf16*)(ws + WS_QS); bf16* VI = (bf16*)(ws + WS_VI); bf16* GA = (bf16*)(ws + WS_GA); bf16* UG = (bf16*)(ws + WS_UG); bf16* GV = (bf16*)(ws + WS_GV);
    float* LOGF = (float*)(ws + WS_LOGF); float* UT = (float*)(ws + WS_UT); bf16* ST = (bf16*)(ws + WS_ST); float* DD = (float*)(ws + WS_D);
    for (int u = tid; u < (LDS_BYTES - LDSCTL_OFF) / 4; u += NWAVES * 64) ((LAS unsigned*)(lds + LDSCTL_OFF))[u] = 0u;
    __syncthreads();
    XcdBarrier bar; bar.bar = (unsigned*)(ctl + CW_BAR); bar.x = 0; bar.st = nullptr;
    if (N_LAUNCHES == 1) bar = xcd_barrier_post((unsigned*)(ctl + CW_BAR), MISC + 8);
    const int lo = args.ph_lo, hi = args.ph_hi;
#define IN(k) (lo <= (k) && (k) < hi)
#define SEAM(k) do { if (IN(k) && IN((k) + 1)) xcd_barrier(bar); } while (0)

    if (IN(0)) { p0_prologue(lds, x_prompt, x_sample, norm_w, w_in, w_out, WIN_T, WOUT_T, HN, vcu, G, wave, lane); }
    SEAM(0);
    if (IN(1)) {
        pg8::Gemm g{HN, WIN_T, MROWS, NIN, DM}; pg8::StaticOrder S; S.init(MROWS, NIN, G, bx);
        EpiIn E{QS, VI, GA, UG, GV, LOGF, lb_logits};
        pg8::gemm_phase<EpiIn, pg8::StaticOrder, true, true>(lds, g, S, E);
    }
    SEAM(1);
    if (IN(2)) { for (int it = bx; it < NTILE * 4; it += G) p2_item(lds, LOGF, VI, UT, DD, it >> 2, it & 3, tid, wave, lane); }
    SEAM(2);
    if (IN(3)) { p3_scan(UT, DD, ST, out + OUT_SP, bx * (NWAVES * 64) + tid, G * NWAVES * 64); }
    SEAM(3);
    if (IN(4)) {
        for (int it = bx; it < 1104; it += G) {
            if (it < 512) p4a_item(lds, LOGF, QS, VI, GA, ST, g_norm_w, Y, it >> 2, it & 3, tid, wave, lane);
            else if (it < 1024) p4b_item(lds, GV, UG, ln_v_w, ln_v_b, w_s, b_s, Y, (it - 512) >> 2, it & 3, tid, wave, lane);
            else if (it < 1088) p4c_item(lds, LOGF, QS, VI, GA, state0, g_norm_w, Y, out + OUT_SS, (it - 1024) >> 2, it & 3, tid);
            else p4d_item(lds, GV, UG, ln_v_w, ln_v_b, w_s, b_s, Y, out + OUT_V, it - 1088, tid, wave, lane);
        }
    }
    SEAM(4);
    if (IN(5)) {
        pg8::Gemm g{Y, WOUT_T, MROWS, DM, DM}; pg8::StaticOrder S; S.init(MROWS, DM, G, bx);
        EpiOutPre E{x_prompt, x_sample, out};
        pg8::gemm_phase<EpiOutPre, pg8::StaticOrder, true, true>(lds, g, S, E);
    }
    SEAM(5);
    if (IN(6)) { p6_final(out, final_norm_w, bx * NWAVES + wave, G * NWAVES, lane); }
#undef IN
#undef SEAM
}

extern "C" void kernel_launch(void* const* d_in, const int* in_sizes, int n_in, void* d_out, int out_size, void* d_ws, size_t ws_size, hipStream_t stream) {
    static int grid = 0;
    if (grid == 0) {
        if (n_in != 13 || out_size != (int)OUT_END || ws_size < WS_END) { fprintf(stderr, "kernel_launch: unexpected shapes (n_in %d, out %d, ws %zu)\n", n_in, out_size, ws_size); grid = -1; return; }
        int dev = 0, cus = 0;
        if (hipGetDevice(&dev) != hipSuccess || hipDeviceGetAttribute(&cus, hipDeviceAttributeMultiprocessorCount, dev) != hipSuccess) { grid = -1; return; }
        if (hipFuncSetAttribute((const void*)fwd_kernel, hipFuncAttributeMaxDynamicSharedMemorySize, LDS_BYTES) != hipSuccess) { fprintf(stderr, "kernel_launch: hipFuncSetAttribute failed\n"); grid = -1; return; }
        int per_cu = 0;
        if (hipOccupancyMaxActiveBlocksPerMultiprocessor(&per_cu, (const void*)fwd_kernel, NWAVES * 64, LDS_BYTES) != hipSuccess || per_cu < 1) fprintf(stderr, "kernel_launch: occupancy query says %d blocks per CU\n", per_cu);
        (void)hipGetLastError();
        grid = cus;
    }
    if (grid < 0) return;
    if (hipMemsetAsync((char*)d_ws + WS_CTL, 0, CTL_ZERO_BYTES, stream) != hipSuccess) return;
    Args a{};
    for (int i = 0; i < 13; ++i) a.in[i] = (const float*)d_in[i];
    a.out = (float*)d_out; a.ws = (unsigned char*)d_ws;
    for (int li = 0; li < N_LAUNCHES; ++li) {
        a.ph_lo = (N_LAUNCHES == 1) ? 0 : li; a.ph_hi = (N_LAUNCHES == 1) ? N_PHASES : li + 1;
        hipLaunchKernelGGL(fwd_kernel, dim3(grid), dim3(NWAVES * 64), LDS_BYTES, stream, a);
    }
}
```
